# Optimizing an MI355X kernel written in HIP

```python
import math
import numpy as np
import jax
import jax.numpy as jnp
from jax import lax

D_MODEL = 1024
BATCH = 8
SEQ = 2048
DEPTH = 4

HEAD_DIM = 64
DIL_PAIRS = ((128, 1), (512, 4), (2048, 16))
N_DIL_GROUPS = len(DIL_PAIRS)
HEADS_PER_DIL_GROUP = 4
N_HEADS_A = N_DIL_GROUPS * HEADS_PER_DIL_GROUP
N_HEADS_B = 8
MOBA_BLOCK = 256
MOBA_TOPK = 3
MOBA_Q_CHUNK = 32
ROPE_THETA = 500000.0
ROT_DIM = HEAD_DIM // 4
D_FF = 4 * D_MODEL
CONV_WIDTH = 3
RMS_EPS = 1e-6
WIDTH_A = N_HEADS_A * HEAD_DIM
WIDTH_A_OUT = HEADS_PER_DIL_GROUP * HEAD_DIM
WIDTH_B = N_HEADS_B * HEAD_DIM
SPLIT_SIZES = (WIDTH_A, WIDTH_A, WIDTH_A, WIDTH_B, WIDTH_B, WIDTH_B, D_MODEL, D_MODEL)
D_IN = sum(SPLIT_SIZES)

kernel_name = "hybrid_dilated_moba_gated_convffn"


def rmsnorm(x, g):
    xf = x.astype(jnp.float32)
    y = xf * lax.rsqrt(jnp.mean(xf * xf, axis=-1, keepdims=True) + RMS_EPS)
    return (y * g.astype(jnp.float32)).astype(x.dtype)


def partial_rope(t, positions):
    half = ROT_DIM // 2
    inv_freq = ROPE_THETA ** (-jnp.arange(0, ROT_DIM, 2, dtype=jnp.float32) / ROT_DIM)
    ang = positions.astype(jnp.float32)[:, None, :, None] * inv_freq
    cos = jnp.cos(ang).astype(t.dtype)
    sin = jnp.sin(ang).astype(t.dtype)
    x1 = t[..., :half]
    x2 = t[..., half:ROT_DIM]
    return jnp.concatenate([x1 * cos - x2 * sin, x2 * cos + x1 * sin, t[..., ROT_DIM:]], axis=-1)


def dilated_group_attention(q, k, v, window, dilation):
    B, H, S, Dh = q.shape
    L = S // dilation
    w = window // dilation
    nb = -(-L // w)
    Lp = nb * w

    def to_sub(t):
        t = t.reshape(B, H, L, dilation, Dh).transpose(0, 1, 3, 2, 4)
        t = jnp.pad(t, ((0, 0), (0, 0), (0, 0), (0, Lp - L), (0, 0)))
        return t.reshape(B, H, dilation, nb, w, Dh)

    qb, kb, vb = to_sub(q), to_sub(k), to_sub(v)

    def with_prev(t):
        prev = jnp.concatenate([jnp.zeros_like(t[:, :, :, :1]), t[:, :, :, :-1]], axis=3)
        return jnp.concatenate([prev, t], axis=4)

    k2, v2 = with_prev(kb), with_prev(vb)
    scores = jnp.einsum('bhrnqd,bhrnkd->bhrnqk', qb, k2).astype(jnp.float32) * (Dh ** -0.5)
    qi = jnp.arange(w)[:, None]
    kj = jnp.arange(2 * w)[None, :]
    dist = w + qi - kj
    band = (dist >= 0) & (dist <= w)
    blk = jnp.arange(nb)[:, None, None]
    valid = band[None] & ((blk > 0) | (kj[None] >= w))
    scores = jnp.where(valid, scores, -jnp.inf)
    lse = jax.nn.logsumexp(scores, axis=-1)
    p = jnp.exp(scores - lse[..., None])
    out = jnp.einsum('bhrnqk,bhrnkd->bhrnqd', p.astype(v.dtype), v2)
    out = out.reshape(B, H, dilation, Lp, Dh)[:, :, :, :L].transpose(0, 1, 3, 2, 4).reshape(B, H, S, Dh)
    lse = lse.reshape(B, H, dilation, Lp)[..., :L].transpose(0, 1, 3, 2).reshape(B, H, S)
    return out, lse


def dilated_mixture_attention(qa, ka, va):
    outs, lses = [], []
    for g, (window, dilation) in enumerate(DIL_PAIRS):
        sl = slice(g * HEADS_PER_DIL_GROUP, (g + 1) * HEADS_PER_DIL_GROUP)
        o, l = dilated_group_attention(qa[:, sl], ka[:, sl], va[:, sl], window, dilation)
        outs.append(o)
        lses.append(l)
    outs = jnp.stack(outs, axis=0)
    alpha = jax.nn.softmax(jnp.stack(lses, axis=0), axis=0)
    return jnp.sum(alpha[..., None].astype(outs.dtype) * outs, axis=0)


def moba_attention(q, k, v):
    B, H, S, Dh = q.shape
    nblk = -(-S // MOBA_BLOCK)
    Sp = nblk * MOBA_BLOCK
    pad = ((0, 0), (0, 0), (0, Sp - S), (0, 0))
    q, k, v = jnp.pad(q, pad), jnp.pad(k, pad), jnp.pad(v, pad)
    kb = k.reshape(B, H, nblk, MOBA_BLOCK, Dh)
    vb = v.reshape(B, H, nblk, MOBA_BLOCK, Dh)
    k_mean = jnp.mean(kb.astype(jnp.float32), axis=3)
    n_chunks = Sp // MOBA_Q_CHUNK
    chunks_per_block = MOBA_BLOCK // MOBA_Q_CHUNK
    k_eff = min(MOBA_TOPK, nblk)
    scale = Dh ** -0.5
    qc = q.reshape(B, H, n_chunks, MOBA_Q_CHUNK, Dh).transpose(2, 0, 1, 3, 4)
    bi = jnp.arange(B)[:, None, None, None]
    hi = jnp.arange(H)[None, :, None, None]

    def one_chunk(args):
        c, q_c = args
        blk = c // chunks_per_block
        gate = jnp.einsum('bhqd,bhnd->bhqn', q_c.astype(jnp.float32), k_mean)
        past = jnp.arange(nblk) < blk
        gate = jnp.where(past, gate, -jnp.inf)
        top_val, top_idx = lax.top_k(gate, k_eff)
        sel_valid = jnp.isfinite(top_val)
        k_sel = kb[bi, hi, top_idx]
        v_sel = vb[bi, hi, top_idx].reshape(B, H, MOBA_Q_CHUNK, k_eff * MOBA_BLOCK, Dh)
        qs = q_c * scale
        s_sel = jnp.einsum('bhqd,bhqjkd->bhqjk', qs, k_sel).astype(jnp.float32)
        s_sel = jnp.where(sel_valid[..., None], s_sel, -jnp.inf).reshape(B, H, MOBA_Q_CHUNK, k_eff * MOBA_BLOCK)
        k_own = lax.dynamic_index_in_dim(kb, blk, axis=2, keepdims=False)
        v_own = lax.dynamic_index_in_dim(vb, blk, axis=2, keepdims=False)
        s_own = jnp.einsum('bhqd,bhkd->bhqk', qs, k_own).astype(jnp.float32)
        q_pos = (c % chunks_per_block) * MOBA_Q_CHUNK + jnp.arange(MOBA_Q_CHUNK)
        causal = jnp.arange(MOBA_BLOCK)[None, :] <= q_pos[:, None]
        s_own = jnp.where(causal, s_own, -jnp.inf)
        p = jax.nn.softmax(jnp.concatenate([s_sel, s_own], axis=-1), axis=-1).astype(v.dtype)
        n_sel = k_eff * MOBA_BLOCK
        return (jnp.einsum('bhqk,bhqkd->bhqd', p[..., :n_sel], v_sel)
                + jnp.einsum('bhqk,bhkd->bhqd', p[..., n_sel:], v_own))

    outs = lax.map(one_chunk, (jnp.arange(n_chunks), qc))
    return outs.transpose(1, 2, 0, 3, 4).reshape(B, H, Sp, Dh)[:, :, :S]


def conv_ffn(h, w_up, conv_w, conv_b, w_down):
    S = h.shape[1]
    u = h @ w_up
    up = jnp.pad(u, ((0, 0), (CONV_WIDTH - 1, 0), (0, 0)))
    u = sum(up[:, j:j + S, :] * conv_w[j] for j in range(CONV_WIDTH)) + conv_b
    gate, val = jnp.split(u, 2, axis=-1)
    return (jax.nn.gelu(gate, approximate=True) * val) @ w_down


def setup_inputs(seed: int = 0) -> dict:
    key = jax.random.key(seed)
    ks = jax.random.split(key, 20)
    f32 = jnp.float32

    def nrm(k, shape, fan_in):
        return jax.random.normal(k, shape, f32) * (fan_in ** -0.5)

    def gain(k):
        return 1.0 + 0.02 * jax.random.normal(k, (DEPTH, D_MODEL), f32)

    x = jax.random.normal(ks[0], (BATCH, SEQ, D_MODEL), f32)
    offsets = jax.random.randint(ks[1], (BATCH,), 0, 4096, dtype=jnp.int32)
    positions = offsets[:, None] + jnp.arange(SEQ, dtype=jnp.int32)[None, :]
    return {
        "x": x,
        "positions": positions,
        "norm_pre_mix": gain(ks[2]),
        "w_in": nrm(ks[3], (DEPTH, D_MODEL, D_IN), D_MODEL),
        "b_gate": 0.01 * jax.random.normal(ks[4], (DEPTH, 2 * D_MODEL), f32),
        "w_proj_a": nrm(ks[5], (DEPTH, WIDTH_A_OUT, D_MODEL), WIDTH_A_OUT),
        "w_proj_b": nrm(ks[6], (DEPTH, WIDTH_B, D_MODEL), WIDTH_B),
        "w_out": nrm(ks[7], (DEPTH, D_MODEL, D_MODEL), D_MODEL),
        "norm_post_mix": gain(ks[8]),
        "norm_pre_ffn": gain(ks[9]),
        "w_up": nrm(ks[10], (DEPTH, D_MODEL, 2 * D_FF), D_MODEL),
        "conv_w": nrm(ks[11], (DEPTH, CONV_WIDTH, 2 * D_FF), CONV_WIDTH),
        "conv_b": 0.01 * jax.random.normal(ks[12], (DEPTH, 2 * D_FF), f32),
        "w_down": nrm(ks[13], (DEPTH, D_FF, D_MODEL), D_FF),
        "norm_post_ffn": gain(ks[14]),
    }


def reference(x, positions, norm_pre_mix, w_in, b_gate, w_proj_a, w_proj_b, w_out, norm_post_mix,
              norm_pre_ffn, w_up, conv_w, conv_b, w_down, norm_post_ffn):
    B, S, _ = x.shape
    split_idx = np.cumsum(SPLIT_SIZES)[:-1].tolist()

    def heads(t, n_heads):
        return t.reshape(B, S, n_heads, HEAD_DIM).transpose(0, 2, 1, 3)

    def merge_heads(t):
        return t.transpose(0, 2, 1, 3).reshape(B, S, -1)

    for l in range(DEPTH):
        h = rmsnorm(x, norm_pre_mix[l])
        proj = h @ w_in[l]
        qa, ka, va, qb, kb, vb, ga, gb = jnp.split(proj, split_idx, axis=-1)
        qa = partial_rope(heads(qa, N_HEADS_A), positions)
        ka = partial_rope(heads(ka, N_HEADS_A), positions)
        qb = partial_rope(heads(qb, N_HEADS_B), positions)
        kb = partial_rope(heads(kb, N_HEADS_B), positions)
        ya = merge_heads(dilated_mixture_attention(qa, ka, heads(va, N_HEADS_A)))
        yb = merge_heads(moba_attention(qb, kb, heads(vb, N_HEADS_B)))
        gate_a = jax.nn.sigmoid(ga + b_gate[l, :D_MODEL])
        gate_b = jax.nn.sigmoid(gb + b_gate[l, D_MODEL:])
        merged = gate_a * (ya @ w_proj_a[l]) + gate_b * (yb @ w_proj_b[l])
        x = x + rmsnorm(merged @ w_out[l], norm_post_mix[l])
        h = rmsnorm(x, norm_pre_ffn[l])
        x = x + rmsnorm(conv_ffn(h, w_up[l], conv_w[l], conv_b[l], w_down[l]), norm_post_ffn[l])
    return x
```

```cpp
#include <hip/hip_runtime.h>
#include <cstdio>
#include <cstdint>
namespace pg8 {
#define PG8_LAS __attribute__((address_space(3)))
typedef unsigned short bf16_t;
typedef short bf16x8 __attribute__((ext_vector_type(8)));
typedef float f32x4 __attribute__((ext_vector_type(4)));
typedef unsigned u32x4 __attribute__((ext_vector_type(4)));
constexpr int BM = 256, BK = 64, HALF = 128, HTB = HALF * BK * 2  , STAGE_BYTES = 8 * HTB, NXCD = 8, WGM = 8;

__host__ __device__ __forceinline__ int lds_byte(int r, int c) { const int st = (r >> 4) * 2 + (c >> 5), rr = r & 15, cc = c & 31, ob = rr * 64 + cc * 2; return st * 1024 + (ob ^ (((ob >> 9) & 1) << 5)); }
__host__ __device__ __forceinline__ void stage_rc(int b, int& R, int& C) { const int st = b / 1024, sb = b % 1024, swz = sb ^ (((sb >> 9) & 1) << 5); R = (st >> 1) * 16 + swz / 64; C = (st & 1) * 32 + (swz % 64) / 2; }
__host__ __device__ __forceinline__ int perm32(int rho) { const int n = rho >> 4, i = rho & 15; return 8 * (i >> 2) + 4 * n + (i & 3); }

struct Unit { int pm, pn; };
struct Gemm { const bf16_t* A; const bf16_t* Bt; int M, N, K, pad; };

struct StaticOrder {
    int nM, nN, nwg, G, c;
    __host__ __device__ void init(int M, int N, int G_, int c_) { nM = M / BM; nN = N / BM; nwg = nM * nN; G = G_; c = c_; }
    __host__ __device__ bool next(int i, Unit& u) const {
        const long L = (long)i * G + c; if (L >= nwg) return false;
        int wgid = (int)L; { const int q = nwg / NXCD, r = nwg % NXCD, xcd = wgid % NXCD, off = wgid / NXCD; wgid = (xcd < r ? xcd * (q + 1) : r * (q + 1) + (xcd - r) * q) + off; }
        const int nig = WGM * nN, gid = wgid / nig, fm = gid * WGM, gsz = (nM - fm) < WGM ? (nM - fm) : WGM;
        u.pm = fm + ((wgid % nig) % gsz); u.pn = (wgid % nig) / gsz; return true;
    }
    __device__ __forceinline__ void a_ready(const Unit&) const {}
    __device__ __forceinline__ void done(const Unit&) const {}
};

__device__ __forceinline__ unsigned cvt_pk_bf16(float lo, float hi) { unsigned r; asm volatile("v_cvt_pk_bf16_f32 %0, %1, %2" : "=v"(r) : "v"(lo), "v"(hi)); return r; }
typedef float f32x2 __attribute__((ext_vector_type(2)));
struct EpiF32 {
    static constexpr bool PERM = false, AFTER_DRAIN = false;
    float* C; const float* bias; int ldc; int pad;
    __device__ __forceinline__ void operator()(const f32x4 (&acc)[2][2][4][2], const Unit& u, int wr, int wc, int fr, int fq) const {
        const int row0 = u.pm * BM + wr * 64 + fr, col0 = u.pn * BM + wc * 32 + 4 * fq;
        f32x4 bv[2][2];
#pragma unroll
        for (int bj = 0; bj < 2; ++bj)
#pragma unroll
            for (int n = 0; n < 2; ++n) bv[bj][n] = bias ? *(const f32x4*)(bias + col0 + bj * HALF + n * 16) : (f32x4){0.f, 0.f, 0.f, 0.f};
#pragma unroll
        for (int ai = 0; ai < 2; ++ai)
#pragma unroll
            for (int m = 0; m < 4; ++m) { float* rowp = C + (size_t)(row0 + ai * HALF + m * 16) * ldc + col0;
#pragma unroll
                for (int bj = 0; bj < 2; ++bj)
#pragma unroll
                    for (int n = 0; n < 2; ++n) *(f32x4*)(rowp + bj * HALF + n * 16) = acc[ai][bj][m][n] + bv[bj][n]; }
    }
};
template <class Epi, class Sched, bool ALIGN_EPI = false, bool SP2 = false>
__device__ __forceinline__ void gemm_phase(PG8_LAS unsigned char* lds, const Gemm g, const Sched& S, const Epi& E) {
    const int tid = threadIdx.x, wid = __builtin_amdgcn_readfirstlane(tid >> 6), lane = tid & 63, wr = wid >> 2, wc = wid & 3, fr = lane & 15, fq = lane >> 4;
    const int K = g.K, nt = K / BK;
    unsigned voffA[2], voffB[2];
#pragma unroll
    for (int i = 0; i < 2; ++i) { int R, C; stage_rc(tid * 16 + i * 8192, R, C); const int Rb = Epi::PERM ? ((R & ~31) + perm32(R & 31)) : R;
        voffA[i] = (unsigned)(R * K + C) * 2u; voffB[i] = (unsigned)(Rb * K + C) * 2u; }
    const size_t kstep = (size_t)(BK * 2);
    const size_t hstep = (size_t)HALF * K * 2;
    const size_t tstep = 2 * hstep;
    const unsigned ldsw = (unsigned)wid * 1024u;
    const int aoff = lds_byte(wr * 64 + fr, fq * 8), boff = lds_byte(wc * 32 + fr, fq * 8);
#define PG8_SA(b, h) (((b) * 2 + (h)) * HTB)
#define PG8_SB(b, h) ((4 + (b) * 2 + (h)) * HTB)
#define PG8_STAGE(bufoff, gbase, voff) do { _Pragma("unroll") for (int _i = 0; _i < 2; ++_i) \
        __builtin_amdgcn_global_load_lds((const unsigned*)((const char*)(gbase) + (voff)[_i]), (PG8_LAS unsigned*)(lds + (bufoff) + ldsw + _i * 8192), 16, 0, 0); } while (0)
#define PG8_LDA(dst, b, h) do { _Pragma("unroll") for (int m = 0; m < 4; ++m) _Pragma("unroll") for (int k = 0; k < 2; ++k) dst[m][k] = *(const PG8_LAS bf16x8*)(lds + PG8_SA(b, h) + aoff + m * 2048 + k * 1024); } while (0)
#define PG8_LDB(dst, b, h) do { _Pragma("unroll") for (int n = 0; n < 2; ++n) _Pragma("unroll") for (int k = 0; k < 2; ++k) dst[n][k] = *(const PG8_LAS bf16x8*)(lds + PG8_SB(b, h) + boff + n * 2048 + k * 1024); } while (0)
#define PG8_MMA(ai, bj, At, Bt) do { __builtin_amdgcn_s_setprio(1); _Pragma("unroll") for (int m = 0; m < 4; ++m) _Pragma("unroll") for (int n = 0; n < 2; ++n) _Pragma("unroll") for (int k = 0; k < 2; ++k) \
        acc[ai][bj][m][n] = __builtin_amdgcn_mfma_f32_16x16x32_bf16(Bt[n][k], At[m][k], acc[ai][bj][m][n], 0, 0, 0); __builtin_amdgcn_s_setprio(0); } while (0)
#define PG8_WAIT_V(n) asm volatile("s_waitcnt vmcnt(" #n ")" ::: "memory")
#define PG8_WAIT_L(n) asm volatile("s_waitcnt lgkmcnt(" #n ")" ::: "memory")
#define PG8_BAR __builtin_amdgcn_s_barrier()
#define PG8_SCHED __builtin_amdgcn_sched_barrier(0)
    Unit cur, nxt; int ui = 0;
    if (!S.next(0, cur)) return;
    f32x4 acc[2][2][4][2];
#pragma unroll
    for (int a = 0; a < 2; ++a)
#pragma unroll
        for (int b = 0; b < 2; ++b)
#pragma unroll
            for (int m = 0; m < 4; ++m)
#pragma unroll
                for (int n = 0; n < 2; ++n) acc[a][b][m][n] = (f32x4){0.f, 0.f, 0.f, 0.f};
    bf16x8 At[4][2], B0[2][2], B1[2][2];
    const char* cA = (const char*)g.A + (size_t)cur.pm * tstep; const char* cB = (const char*)g.Bt + (size_t)cur.pn * tstep;
    S.a_ready(cur);
    if constexpr (SP2) {
        PG8_STAGE(PG8_SB(0, 0), cB, voffB); PG8_STAGE(PG8_SB(0, 1), cB + hstep, voffB); PG8_STAGE(PG8_SA(0, 0), cA, voffA); PG8_STAGE(PG8_SA(0, 1), cA + hstep, voffA);
        if (wr == 1) PG8_BAR;
        PG8_WAIT_V(2); PG8_BAR;
        PG8_STAGE(PG8_SB(1, 0), cB + kstep, voffB); PG8_STAGE(PG8_SA(1, 0), cA + kstep, voffA); PG8_STAGE(PG8_SB(1, 1), cB + hstep + kstep, voffB);
        PG8_WAIT_V(6); PG8_BAR;
    } else {
        PG8_STAGE(PG8_SB(0, 0), cB, voffB); PG8_STAGE(PG8_SA(0, 0), cA, voffA); PG8_STAGE(PG8_SB(0, 1), cB + hstep, voffB); PG8_STAGE(PG8_SA(0, 1), cA + hstep, voffA);
        if (wr == 1) PG8_BAR;
        PG8_WAIT_V(4); PG8_BAR;
        PG8_STAGE(PG8_SB(1, 0), cB + kstep, voffB); PG8_STAGE(PG8_SA(1, 0), cA + kstep, voffA); PG8_STAGE(PG8_SB(1, 1), cB + hstep + kstep, voffB);
        PG8_WAIT_V(6); PG8_BAR;
    }
    for (;;) {
        const bool has_next = S.next(ui + 1, nxt);
        const char* nA = has_next ? (const char*)g.A + (size_t)nxt.pm * tstep : cA; const char* nB = has_next ? (const char*)g.Bt + (size_t)nxt.pn * tstep : cB;
        for (int t = 0; t < nt; t += 2) {
            const bool last = (t == nt - 2);
            const char* a1 = cA + (size_t)(t + 1) * kstep;
            const char* a2 = last ? nA : cA + (size_t)(t + 2) * kstep; const char* b2 = last ? nB : cB + (size_t)(t + 2) * kstep;
            const char* a3 = a2 + kstep; const char* b3 = b2 + kstep;
            if (last && has_next) S.a_ready(nxt);
            if constexpr (SP2) {
            PG8_LDB(B0, 0, 0); PG8_LDB(B1, 0, 1); PG8_SCHED; PG8_LDA(At, 0, 0); PG8_STAGE(PG8_SA(1, 1), a1 + hstep, voffA);
            PG8_WAIT_V(8); PG8_WAIT_L(0); PG8_BAR; PG8_MMA(0, 0, At, B0); PG8_MMA(0, 1, At, B1); PG8_BAR; PG8_SCHED;
            PG8_LDA(At, 0, 1); PG8_STAGE(PG8_SB(0, 0), b2, voffB); PG8_STAGE(PG8_SB(0, 1), b2 + hstep, voffB); PG8_STAGE(PG8_SA(0, 0), a2, voffA);
            PG8_WAIT_V(8); PG8_WAIT_L(0); PG8_BAR; PG8_MMA(1, 0, At, B0); PG8_MMA(1, 1, At, B1); PG8_BAR; PG8_SCHED;
            PG8_LDB(B0, 1, 0); PG8_LDB(B1, 1, 1); PG8_SCHED; PG8_LDA(At, 1, 0); PG8_STAGE(PG8_SA(0, 1), a2 + hstep, voffA);
            PG8_WAIT_V(8); PG8_WAIT_L(0); PG8_BAR; PG8_MMA(0, 0, At, B0); PG8_MMA(0, 1, At, B1); PG8_BAR; PG8_SCHED;
            PG8_LDA(At, 1, 1); PG8_STAGE(PG8_SB(1, 0), b3, voffB); PG8_STAGE(PG8_SB(1, 1), b3 + hstep, voffB); PG8_STAGE(PG8_SA(1, 0), a3, voffA);
            PG8_WAIT_V(8); PG8_WAIT_L(0); PG8_BAR; PG8_MMA(1, 0, At, B0); PG8_MMA(1, 1, At, B1); PG8_BAR; PG8_SCHED;
            } else {
            PG8_LDB(B0, 0, 0); PG8_SCHED; PG8_LDA(At, 0, 0); PG8_STAGE(PG8_SA(1, 1), a1 + hstep, voffA);
            PG8_WAIT_L(8); PG8_BAR; PG8_WAIT_L(0); PG8_MMA(0, 0, At, B0); PG8_BAR; PG8_SCHED;
            PG8_LDB(B1, 0, 1); PG8_STAGE(PG8_SB(0, 0), b2, voffB);
            PG8_BAR; PG8_WAIT_L(0); PG8_MMA(0, 1, At, B1); PG8_BAR;
            PG8_LDA(At, 0, 1); PG8_STAGE(PG8_SA(0, 0), a2, voffA);
            PG8_BAR; PG8_WAIT_L(0); PG8_MMA(1, 0, At, B0); PG8_BAR; PG8_SCHED;
            PG8_STAGE(PG8_SB(0, 1), b2 + hstep, voffB);
            PG8_WAIT_V(6); PG8_BAR; PG8_MMA(1, 1, At, B1); PG8_BAR;
            PG8_LDB(B0, 1, 0); PG8_SCHED; PG8_LDA(At, 1, 0); PG8_STAGE(PG8_SA(0, 1), a2 + hstep, voffA);
            PG8_WAIT_L(8); PG8_BAR; PG8_WAIT_L(0); PG8_MMA(0, 0, At, B0); PG8_BAR; PG8_SCHED;
            PG8_LDB(B1, 1, 1); PG8_STAGE(PG8_SB(1, 0), b3, voffB);
            PG8_BAR; PG8_WAIT_L(0); PG8_MMA(0, 1, At, B1); PG8_BAR;
            PG8_LDA(At, 1, 1); PG8_STAGE(PG8_SA(1, 0), a3, voffA);
            PG8_BAR; PG8_WAIT_L(0); PG8_MMA(1, 0, At, B0); PG8_BAR; PG8_SCHED;
            PG8_STAGE(PG8_SB(1, 1), b3 + hstep, voffB);
            PG8_WAIT_V(6); PG8_BAR; PG8_MMA(1, 1, At, B1); PG8_BAR;
            }
        }
        if constexpr (ALIGN_EPI) { if (wr == 0) PG8_BAR; }
        if constexpr (!Epi::AFTER_DRAIN) { E(acc, cur, wr, wc, fr, fq); S.done(cur); }
        if (!has_next) break;
#pragma unroll
        for (int a = 0; a < 2; ++a)
#pragma unroll
            for (int b = 0; b < 2; ++b)
#pragma unroll
                for (int m = 0; m < 4; ++m)
#pragma unroll
                    for (int n = 0; n < 2; ++n) acc[a][b][m][n] = (f32x4){0.f, 0.f, 0.f, 0.f};
        cur = nxt; cA = nA; cB = nB; ++ui;
        if constexpr (ALIGN_EPI) { if (wr == 1) PG8_BAR; }
    }
    PG8_WAIT_V(0);
    if constexpr (!ALIGN_EPI) { if (wr == 0) PG8_BAR; }
    PG8_BAR;
    if constexpr (Epi::AFTER_DRAIN) { E.fused(acc, cur, wr, wc, fr, fq, lds, wid, lane); S.done(cur); }
#undef PG8_SA
#undef PG8_SB
#undef PG8_STAGE
#undef PG8_LDA
#undef PG8_LDB
#undef PG8_MMA
#undef PG8_WAIT_V
#undef PG8_WAIT_L
#undef PG8_BAR
#undef PG8_SCHED
}
}

typedef unsigned short bf16_t;
typedef float f32x4 __attribute__((ext_vector_type(4)));
typedef unsigned u32x4 __attribute__((ext_vector_type(4)));
#define LAS __attribute__((address_space(3)))

constexpr int NB = 8, SEQ = 2048, DM = 1024, MROWS = NB * SEQ, NLAYER = 4, DIN = 5888, DFF = 4096;
constexpr int NHA = 12, NHB = 8, HD = 64;
constexpr float RMS_EPS = 1e-6f;
constexpr int NTHREADS = 512, NWAVES = 8;

constexpr size_t MiB = 1u << 20;
constexpr size_t WS_CTL = 0;
constexpr size_t WS_WIN = 1 * MiB, WS_WA = 47 * MiB, WS_WB = 49 * MiB, WS_WO = 53 * MiB, WS_WUP = 61 * MiB, WS_WD = 125 * MiB;
constexpr size_t WS_XB = 157 * MiB, WS_SSQ = 189 * MiB, WS_CS = 190 * MiB, WS_KMEAN = 191 * MiB;
constexpr size_t WS_QA = 192 * MiB, WS_KA = 216 * MiB, WS_VA = 240 * MiB, WS_QB = 264 * MiB, WS_KB = 280 * MiB, WS_VB = 296 * MiB;
constexpr size_t WS_GA = 312 * MiB, WS_GB = 344 * MiB, WS_OUTA = 376 * MiB, WS_LSEA = 400 * MiB, WS_YA = 401 * MiB, WS_YB = 409 * MiB;
constexpr size_t WS_SCR = 425 * MiB;
constexpr size_t WS_ACT = 192 * MiB;
constexpr size_t WS_T1 = 192 * MiB, WS_MERGED = 256 * MiB, WS_Y = 320 * MiB;
constexpr size_t WS_END = 512 * MiB;

constexpr size_t WIN_L = (size_t)DIN * DM, WA_L = (size_t)DM * 256, WB_L = (size_t)DM * 512, WO_L = (size_t)DM * DM, WUP_L = (size_t)2 * DFF * DM, WD_L = (size_t)DM * DFF;

__device__ __forceinline__ float bf2f(bf16_t v) { return __uint_as_float(((unsigned)v) << 16); }
__device__ __forceinline__ unsigned f2bf(float f) { unsigned u = __float_as_uint(f); return (u + 0x7fffu + ((u >> 16) & 1u)) >> 16; }
__device__ __forceinline__ unsigned pk2(float lo, float hi) { return f2bf(lo) | (f2bf(hi) << 16); }
__device__ __forceinline__ float wave_sum(float v) {
#pragma unroll
    for (int o = 1; o < 64; o <<= 1) v += __shfl_xor(v, o);
    return v;
}
__device__ __forceinline__ float sigmoidf_(float x) { return 1.0f / (1.0f + __expf(-x)); }
__device__ __forceinline__ float gelu_tanh(float x) {
    const float z = 0.7978845608028654f * (x + 0.044715f * x * x * x);
    return x / (1.0f + __expf(-2.0f * z));
}

template <int MODE>
__device__ __forceinline__ int rowmap(int n) {
    if (MODE == 0) return n;
    const int half = n >= DFF ? 1 : 0, c = n - half * DFF;
    return (c >> 7) * 256 + half * 128 + (c & 127);
}
template <int MODE>
__device__ __forceinline__ void transpose_item(const float* __restrict__ W, int K, int N, bf16_t* __restrict__ WT, const float* __restrict__ kscale, LAS float* scr, int item, int lane) {
    const int nblk = N / 32, kb = item / nblk, nb = item % nblk, k0 = 64 * kb, n0 = 32 * nb;
#pragma unroll 8
    for (int i = 0; i < 32; ++i) { const int kk = 2 * i + (lane >> 5); float v = W[(size_t)(k0 + kk) * N + n0 + (lane & 31)]; if (kscale) v *= kscale[k0 + kk]; scr[kk * 33 + (lane & 31)] = v; }
    asm volatile("s_waitcnt lgkmcnt(0)" ::: "memory");
    const int c = lane & 7;
#pragma unroll
    for (int j = 0; j < 4; ++j) { const int n = (lane >> 3) + 8 * j; const LAS float* s = scr + (8 * c) * 33 + n;
        u32x4 o; o.x = pk2(s[0 * 33], s[1 * 33]); o.y = pk2(s[2 * 33], s[3 * 33]); o.z = pk2(s[4 * 33], s[5 * 33]); o.w = pk2(s[6 * 33], s[7 * 33]);
        *(u32x4*)(WT + (size_t)rowmap<MODE>(n0 + n) * K + k0 + 8 * c) = o; }
    asm volatile("s_waitcnt lgkmcnt(0)" ::: "memory");
}
template <int MODE>
__device__ __forceinline__ void prep_matrix(const float* W, int K, int N, bf16_t* WT, const float* kscale, LAS float* scr, int gw, int ngw, int lane) {
    const int nitems = (K / 64) * (N / 32);
    for (int it = gw; it < nitems; it += ngw) transpose_item<MODE>(W, K, N, WT, kscale, scr, it, lane);
}

struct Params {
    const float* x; const int* pos; const float* norm_pre_mix; const float* w_in; const float* b_gate; const float* w_proj_a; const float* w_proj_b; const float* w_out;
    const float* norm_post_mix; const float* norm_pre_ffn; const float* w_up; const float* conv_w; const float* conv_b; const float* w_down; const float* norm_post_ffn;
    float* out; unsigned char* ws;
};

__global__ void __launch_bounds__(NTHREADS, 2) k_prep_w(Params p) {
    extern __shared__ __attribute__((aligned(16))) unsigned char lds[];
    const int tid = threadIdx.x, lane = tid & 63, wave = tid >> 6;
    LAS float* scr = (LAS float*)((LAS unsigned char*)lds + wave * 16384);
    const int gw = blockIdx.x * NWAVES + wave, ngw = gridDim.x * NWAVES;
    for (int l = 0; l < NLAYER; ++l) {
        prep_matrix<0>(p.w_in + (size_t)l * DM * DIN, DM, DIN, (bf16_t*)(p.ws + WS_WIN) + l * WIN_L, p.norm_pre_mix + l * DM, scr, gw, ngw, lane);
        prep_matrix<0>(p.w_proj_a + (size_t)l * 256 * DM, 256, DM, (bf16_t*)(p.ws + WS_WA) + l * WA_L, nullptr, scr, gw, ngw, lane);
        prep_matrix<0>(p.w_proj_b + (size_t)l * 512 * DM, 512, DM, (bf16_t*)(p.ws + WS_WB) + l * WB_L, nullptr, scr, gw, ngw, lane);
        prep_matrix<0>(p.w_out + (size_t)l * DM * DM, DM, DM, (bf16_t*)(p.ws + WS_WO) + l * WO_L, nullptr, scr, gw, ngw, lane);
        prep_matrix<1>(p.w_up + (size_t)l * DM * 2 * DFF, DM, 2 * DFF, (bf16_t*)(p.ws + WS_WUP) + l * WUP_L, p.norm_pre_ffn + l * DM, scr, gw, ngw, lane);
        prep_matrix<0>(p.w_down + (size_t)l * DFF * DM, DFF, DM, (bf16_t*)(p.ws + WS_WD) + l * WD_L, nullptr, scr, gw, ngw, lane);
    }
}

__global__ void __launch_bounds__(NTHREADS, 2) k_prep_x(Params p) {
    const int tid = threadIdx.x, lane = tid & 63, wave = tid >> 6;
    const int gw = blockIdx.x * NWAVES + wave, ngw = gridDim.x * NWAVES;
    bf16_t* xb = (bf16_t*)(p.ws + WS_XB); float* ssq = (float*)(p.ws + WS_SSQ); float* cs = (float*)(p.ws + WS_CS);
    for (int m = gw; m < MROWS; m += ngw) {
        const f32x4* xr = (const f32x4*)(p.x + (size_t)m * DM) + lane; f32x4* orow = (f32x4*)(p.out + (size_t)m * DM) + lane;
        unsigned long long* o8 = (unsigned long long*)(xb + (size_t)m * DM) + lane;
        float s = 0.f;
#pragma unroll
        for (int j = 0; j < 4; ++j) { const f32x4 v = xr[64 * j]; s += (v.x * v.x + v.y * v.y) + (v.z * v.z + v.w * v.w); orow[64 * j] = v;
            o8[64 * j] = (unsigned long long)pk2(v.x, v.y) | ((unsigned long long)pk2(v.z, v.w) << 32); }
        s = wave_sum(s);
        if (lane == 0) *(f32x4*)(ssq + (size_t)m * 4) = (f32x4){s, 0.f, 0.f, 0.f};
        if (lane < 8) {
            const float inv = exp2f(-(float)lane * (18.931568569324174f / 8.0f));
            const float ang = (float)p.pos[m] * inv;
            const double k = rint((double)ang * 0.15915494309189535);
            const float r = (float)((double)ang - k * 6.283185307179586);
            cs[(size_t)m * 16 + lane] = cosf(r); cs[(size_t)m * 16 + 8 + lane] = sinf(r);
        }
    }
}

template <class Epi>
__global__ void __launch_bounds__(NTHREADS, 2) k_gemm(pg8::Gemm g, Epi E) {
    extern __shared__ __attribute__((aligned(16))) unsigned char lds[];
    pg8::StaticOrder S; S.init(g.M, g.N, gridDim.x, (int)blockIdx.x);
    pg8::gemm_phase<Epi, pg8::StaticOrder, true, true>((PG8_LAS unsigned char*)lds, g, S, E);
}

__device__ __forceinline__ float row_rstd(const float* ssq, int row) { const f32x4 s = *(const f32x4*)(ssq + (size_t)row * 4); return rsqrtf(((s.x + s.y) + (s.z + s.w)) * (1.0f / DM) + RMS_EPS); }
__device__ __forceinline__ int dil_of_head(int head) { return head < 4 ? 1 : (head < 8 ? 4 : 16); }
__device__ __forceinline__ int vidx(int s, int d) { return (s % d) * (SEQ / d) + s / d; }

__global__ void __launch_bounds__(256) k_post_proj(const float* __restrict__ P, int row0, int nrows, Params p, int layer) {
    const float* ssq = (const float*)(p.ws + WS_SSQ); const float* cs = (const float*)(p.ws + WS_CS);
    bf16_t* QA = (bf16_t*)(p.ws + WS_QA); bf16_t* KA = (bf16_t*)(p.ws + WS_KA); bf16_t* VA = (bf16_t*)(p.ws + WS_VA);
    bf16_t* QB = (bf16_t*)(p.ws + WS_QB); bf16_t* KB = (bf16_t*)(p.ws + WS_KB); bf16_t* VB = (bf16_t*)(p.ws + WS_VB);
    bf16_t* GA = (bf16_t*)(p.ws + WS_GA); bf16_t* GB = (bf16_t*)(p.ws + WS_GB);
    const float* bg = p.b_gate + (size_t)layer * 2 * DM;
    const long total = (long)nrows * (DIN / 8);
    for (long idx = (long)blockIdx.x * blockDim.x + threadIdx.x; idx < total; idx += (long)gridDim.x * blockDim.x) {
        const int rl = (int)(idx / (DIN / 8)), c8 = (int)(idx % (DIN / 8)), row = row0 + rl, col = c8 * 8;
        const float* pr = P + (size_t)rl * DIN;
        const float rstd = row_rstd(ssq, row);
        const f32x4 a0 = *(const f32x4*)(pr + col), a1 = *(const f32x4*)(pr + col + 4);
        float v[8] = {a0.x * rstd, a0.y * rstd, a0.z * rstd, a0.w * rstd, a1.x * rstd, a1.y * rstd, a1.z * rstd, a1.w * rstd};
        const int b = row / SEQ, s = row % SEQ;
        bf16_t* dst;
        if (col < 3840) {
            int which, head, hc, nh; bool isA = col < 2304;
            if (isA) { which = col / 768; const int cc = col % 768; head = cc / 64; hc = cc % 64; nh = NHA; }
            else { const int c2 = col - 2304; which = c2 / 512; const int cc = c2 % 512; head = cc / 64; hc = cc % 64; nh = NHB; }
            if (which < 2 && hc < 16) {
                const int pc = hc == 0 ? col + 8 : col - 8;
                const f32x4 b0 = *(const f32x4*)(pr + pc), b1 = *(const f32x4*)(pr + pc + 4);
                const float w[8] = {b0.x * rstd, b0.y * rstd, b0.z * rstd, b0.w * rstd, b1.x * rstd, b1.y * rstd, b1.z * rstd, b1.w * rstd};
                const float* csr = cs + (size_t)row * 16;
#pragma unroll
                for (int i = 0; i < 8; ++i) { const float c = csr[i], sn = csr[8 + i]; v[i] = hc == 0 ? v[i] * c - w[i] * sn : v[i] * c + w[i] * sn; }
            }
            if (isA) { const int d = dil_of_head(head); const int vi = vidx(s, d);
                dst = (which == 0 ? QA : which == 1 ? KA : VA) + ((size_t)(b * NHA + head) * SEQ + vi) * HD + hc; }
            else dst = (which == 0 ? QB : which == 1 ? KB : VB) + ((size_t)(b * NHB + head) * SEQ + s) * HD + hc;
            (void)nh;
        } else {
            const int c2 = col - 3840;
#pragma unroll
            for (int i = 0; i < 8; ++i) v[i] = sigmoidf_(v[i] + bg[c2 + i]);
            dst = (c2 < DM ? GA : GB) + (size_t)row * DM + (c2 & (DM - 1));
        }
        u32x4 o; o.x = pk2(v[0], v[1]); o.y = pk2(v[2], v[3]); o.z = pk2(v[4], v[5]); o.w = pk2(v[6], v[7]);
        *(u32x4*)dst = o;
    }
}

__global__ void __launch_bounds__(256) k_kmean(Params p, int layer) {
    const bf16_t* KB = (const bf16_t*)(p.ws + WS_KB); float* km = (float*)(p.ws + WS_KMEAN) + (size_t)layer * NB * NHB * 8 * HD;
    const int idx = blockIdx.x * blockDim.x + threadIdx.x;
    if (idx >= NB * NHB * 8 * HD) return;
    const int d = idx % HD, blk = (idx / HD) % 8, bh = idx / (HD * 8);
    const bf16_t* k = KB + ((size_t)bh * SEQ + blk * 256) * HD + d; float s = 0.f;
    for (int t = 0; t < 256; ++t) s += bf2f(k[(size_t)t * HD]);
    km[idx] = s * (1.0f / 256.0f);
}

__global__ void __launch_bounds__(256) k_attn_a_naive(Params p) {
    const bf16_t* QA = (const bf16_t*)(p.ws + WS_QA); const bf16_t* KA = (const bf16_t*)(p.ws + WS_KA); const bf16_t* VA = (const bf16_t*)(p.ws + WS_VA);
    bf16_t* YA = (bf16_t*)(p.ws + WS_YA);
    const int lane = threadIdx.x & 63; const long gw = ((long)blockIdx.x * blockDim.x + threadIdx.x) >> 6, ngw = ((long)gridDim.x * blockDim.x) >> 6;
    for (long w = gw; w < (long)NB * 4 * SEQ; w += ngw) {
        const int s = (int)(w % SEQ), j = (int)((w / SEQ) % 4), b = (int)(w / (SEQ * 4));
        float m = -INFINITY, l = 0.f, o = 0.f;
        for (int g = 0; g < 3; ++g) {
            const int d = g == 0 ? 1 : (g == 1 ? 4 : 16), L = SEQ / d, head = 4 * g + j, i = s / d, r = s % d;
            const size_t base = (size_t)(b * NHA + head) * SEQ + (size_t)r * L;
            const float q = bf2f(QA[(base + i) * HD + lane]);
            const int jlo = i - 128 < 0 ? 0 : i - 128;
            for (int jj = jlo; jj <= i; ++jj) {
                const float k = bf2f(KA[(base + jj) * HD + lane]), v = bf2f(VA[(base + jj) * HD + lane]);
                const float sc = wave_sum(q * k) * 0.125f;
                const float mn = fmaxf(m, sc), al = __expf(m - mn), pe = __expf(sc - mn);
                l = l * al + pe; o = o * al + pe * v; m = mn;
            }
        }
        YA[((size_t)b * SEQ + s) * 256 + j * HD + lane] = (bf16_t)f2bf(o / l);
    }
}

__global__ void __launch_bounds__(256) k_attn_b_naive(Params p, int layer) {
    const bf16_t* QB = (const bf16_t*)(p.ws + WS_QB); const bf16_t* KB = (const bf16_t*)(p.ws + WS_KB); const bf16_t* VB = (const bf16_t*)(p.ws + WS_VB);
    const float* km = (const float*)(p.ws + WS_KMEAN) + (size_t)layer * NB * NHB * 8 * HD;
    bf16_t* YB = (bf16_t*)(p.ws + WS_YB);
    const int lane = threadIdx.x & 63; const long gw = ((long)blockIdx.x * blockDim.x + threadIdx.x) >> 6, ngw = ((long)gridDim.x * blockDim.x) >> 6;
    for (long w = gw; w < (long)NB * NHB * SEQ; w += ngw) {
        const int s = (int)(w % SEQ), h = (int)((w / SEQ) % NHB), b = (int)(w / (SEQ * NHB));
        const int n = s / 256; const size_t base = (size_t)(b * NHB + h) * SEQ;
        const float q = bf2f(QB[(base + s) * HD + lane]);
        float gt[8];
#pragma unroll
        for (int blk = 0; blk < 8; ++blk) gt[blk] = wave_sum(q * km[((size_t)(b * NHB + h) * 8 + blk) * HD + lane]);
        unsigned sel = 0;
#pragma unroll
        for (int blk = 0; blk < 8; ++blk) { int rank = 0;
#pragma unroll
            for (int o2 = 0; o2 < 8; ++o2) if (o2 < n && o2 != blk && (gt[o2] > gt[blk] || (gt[o2] == gt[blk] && o2 < blk))) ++rank;
            if (blk < n && rank < 3) sel |= 1u << blk; }
        float m = -INFINITY, l = 0.f, o = 0.f;
        for (int blk = 0; blk <= n; ++blk) {
            if (blk < n && !((sel >> blk) & 1u)) continue;
            const int k0 = blk * 256, k1 = blk < n ? k0 + 255 : s;
            for (int kk = k0; kk <= k1; ++kk) {
                const float k = bf2f(KB[(base + kk) * HD + lane]), v = bf2f(VB[(base + kk) * HD + lane]);
                const float sc = wave_sum(q * k) * 0.125f;
                const float mn = fmaxf(m, sc), al = __expf(m - mn), pe = __expf(sc - mn);
                l = l * al + pe; o = o * al + pe * v; m = mn;
            }
        }
        YB[((size_t)b * SEQ + s) * 512 + h * HD + lane] = (bf16_t)f2bf(o / l);
    }
}

__global__ void __launch_bounds__(256) k_gate_merge(const float* __restrict__ t1, const float* __restrict__ t2, Params p) {
    const bf16_t* GA = (const bf16_t*)(p.ws + WS_GA); const bf16_t* GB = (const bf16_t*)(p.ws + WS_GB); bf16_t* MG = (bf16_t*)(p.ws + WS_MERGED);
    const long total = (long)MROWS * DM / 4;
    for (long idx = (long)blockIdx.x * blockDim.x + threadIdx.x; idx < total; idx += (long)gridDim.x * blockDim.x) {
        const f32x4 a = ((const f32x4*)t1)[idx], c = ((const f32x4*)t2)[idx];
        const unsigned long long ga = ((const unsigned long long*)GA)[idx], gb = ((const unsigned long long*)GB)[idx];
        float r[4];
#pragma unroll
        for (int i = 0; i < 4; ++i) r[i] = bf2f((bf16_t)(ga >> (16 * i))) * a[i] + bf2f((bf16_t)(gb >> (16 * i))) * c[i];
        ((unsigned long long*)MG)[idx] = (unsigned long long)pk2(r[0], r[1]) | ((unsigned long long)pk2(r[2], r[3]) << 32);
    }
}

__global__ void __launch_bounds__(NTHREADS, 2) k_rownorm(const float* __restrict__ y, const float* __restrict__ g, Params p) {
    const int tid = threadIdx.x, lane = tid & 63, wave = tid >> 6;
    const int gw = blockIdx.x * NWAVES + wave, ngw = gridDim.x * NWAVES;
    bf16_t* xb = (bf16_t*)(p.ws + WS_XB); float* ssq = (float*)(p.ws + WS_SSQ);
    for (int m = gw; m < MROWS; m += ngw) {
        const f32x4* yr = (const f32x4*)(y + (size_t)m * DM) + lane; f32x4* xr = (f32x4*)(p.out + (size_t)m * DM) + lane;
        unsigned long long* o8 = (unsigned long long*)(xb + (size_t)m * DM) + lane;
        f32x4 yv[4]; float s = 0.f;
#pragma unroll
        for (int j = 0; j < 4; ++j) { yv[j] = yr[64 * j]; s += (yv[j].x * yv[j].x + yv[j].y * yv[j].y) + (yv[j].z * yv[j].z + yv[j].w * yv[j].w); }
        s = wave_sum(s);
        const float rstd = rsqrtf(s * (1.0f / DM) + RMS_EPS); float s2 = 0.f;
#pragma unroll
        for (int j = 0; j < 4; ++j) { const f32x4 gv = ((const f32x4*)g)[lane + 64 * j]; f32x4 xv = xr[64 * j];
            xv = xv + yv[j] * rstd * gv; xr[64 * j] = xv; s2 += (xv.x * xv.x + xv.y * xv.y) + (xv.z * xv.z + xv.w * xv.w);
            o8[64 * j] = (unsigned long long)pk2(xv.x, xv.y) | ((unsigned long long)pk2(xv.z, xv.w) << 32); }
        s2 = wave_sum(s2);
        if (lane == 0) *(f32x4*)(ssq + (size_t)m * 4) = (f32x4){s2, 0.f, 0.f, 0.f};
    }
}

__global__ void __launch_bounds__(256) k_conv_act(const float* __restrict__ U, int row0, int nrows, Params p, int layer) {
    const float* ssq = (const float*)(p.ws + WS_SSQ); bf16_t* ACT = (bf16_t*)(p.ws + WS_ACT);
    const float* cw = p.conv_w + (size_t)layer * 3 * 2 * DFF; const float* cb = p.conv_b + (size_t)layer * 2 * DFF;
    const long total = (long)nrows * (DFF / 4);
    for (long idx = (long)blockIdx.x * blockDim.x + threadIdx.x; idx < total; idx += (long)gridDim.x * blockDim.x) {
        const int rl = (int)(idx / (DFF / 4)), c = (int)(idx % (DFF / 4)) * 4, row = row0 + rl, s = row % SEQ;
        const int gi = (c >> 7) * 256 + (c & 127), vi = gi + 128;
        f32x4 ug = {0.f, 0.f, 0.f, 0.f}, uv = {0.f, 0.f, 0.f, 0.f};
#pragma unroll
        for (int tap = 0; tap < 3; ++tap) {
            const int dt = 2 - tap; if (s - dt < 0) continue;
            const float rstd = row_rstd(ssq, row - dt);
            const float* ur = U + (size_t)(rl - dt) * (2 * DFF);
            const f32x4 wg = *(const f32x4*)(cw + (size_t)tap * 2 * DFF + c), wv = *(const f32x4*)(cw + (size_t)tap * 2 * DFF + DFF + c);
            ug += *(const f32x4*)(ur + gi) * rstd * wg; uv += *(const f32x4*)(ur + vi) * rstd * wv;
        }
        ug += *(const f32x4*)(cb + c); uv += *(const f32x4*)(cb + DFF + c);
        float r[4];
#pragma unroll
        for (int i = 0; i < 4; ++i) r[i] = gelu_tanh(ug[i]) * uv[i];
        *(unsigned long long*)(ACT + (size_t)row * DFF + c) = (unsigned long long)pk2(r[0], r[1]) | ((unsigned long long)pk2(r[2], r[3]) << 32);
    }
}

constexpr int GEMM_LDS = 131072;
template <class Epi> static void launch_gemm(const bf16_t* A, const bf16_t* Bt, int M, int N, int K, const Epi& E, hipStream_t stream) {
    pg8::Gemm g{A, Bt, M, N, K};
    hipLaunchKernelGGL(k_gemm<Epi>, dim3(256), dim3(NTHREADS), GEMM_LDS, stream, g, E);
}

extern "C" void kernel_launch(void* const* d_in, const int* in_sizes, int n_in, void* d_out, int out_size, void* d_ws, size_t ws_size, hipStream_t stream) {
    static bool inited = false;
    if (!inited) {
        if (ws_size < WS_END) fprintf(stderr, "kernel_launch: ws_size %zu < %zu\n", ws_size, (size_t)WS_END);
        (void)hipFuncSetAttribute((const void*)k_gemm<pg8::EpiF32>, hipFuncAttributeMaxDynamicSharedMemorySize, GEMM_LDS);
        (void)hipFuncSetAttribute((const void*)k_prep_w, hipFuncAttributeMaxDynamicSharedMemorySize, GEMM_LDS);
        inited = true;
    }
    Params p{};
    p.x = (const float*)d_in[0]; p.pos = (const int*)d_in[1]; p.norm_pre_mix = (const float*)d_in[2]; p.w_in = (const float*)d_in[3]; p.b_gate = (const float*)d_in[4];
    p.w_proj_a = (const float*)d_in[5]; p.w_proj_b = (const float*)d_in[6]; p.w_out = (const float*)d_in[7]; p.norm_post_mix = (const float*)d_in[8]; p.norm_pre_ffn = (const float*)d_in[9];
    p.w_up = (const float*)d_in[10]; p.conv_w = (const float*)d_in[11]; p.conv_b = (const float*)d_in[12]; p.w_down = (const float*)d_in[13]; p.norm_post_ffn = (const float*)d_in[14];
    p.out = (float*)d_out; p.ws = (unsigned char*)d_ws;
    unsigned char* ws = p.ws;
    hipLaunchKernelGGL(k_prep_w, dim3(256), dim3(NTHREADS), GEMM_LDS, stream, p);
    hipLaunchKernelGGL(k_prep_x, dim3(256), dim3(NTHREADS), 0, stream, p);
    const bf16_t* xb = (const bf16_t*)(ws + WS_XB);
    for (int l = 0; l < NLAYER; ++l) {
        for (int c = 0; c < NB; ++c) {
            float* P = (float*)(ws + WS_SCR);
            launch_gemm(xb + (size_t)c * SEQ * DM, (const bf16_t*)(ws + WS_WIN) + l * WIN_L, SEQ, DIN, DM, pg8::EpiF32{P, nullptr, DIN, 0}, stream);
            hipLaunchKernelGGL(k_post_proj, dim3(2048), dim3(256), 0, stream, (const float*)P, c * SEQ, SEQ, p, l);
        }
        hipLaunchKernelGGL(k_kmean, dim3(NB * NHB * 8 * HD / 256), dim3(256), 0, stream, p, l);
        hipLaunchKernelGGL(k_attn_a_naive, dim3(4096), dim3(256), 0, stream, p);
        hipLaunchKernelGGL(k_attn_b_naive, dim3(4096), dim3(256), 0, stream, p, l);
        float* t1 = (float*)(ws + WS_T1); float* t2 = (float*)(ws + WS_SCR); float* y = (float*)(ws + WS_Y);
        launch_gemm((const bf16_t*)(ws + WS_YA), (const bf16_t*)(ws + WS_WA) + l * WA_L, MROWS, DM, 256, pg8::EpiF32{t1, nullptr, DM, 0}, stream);
        launch_gemm((const bf16_t*)(ws + WS_YB), (const bf16_t*)(ws + WS_WB) + l * WB_L, MROWS, DM, 512, pg8::EpiF32{t2, nullptr, DM, 0}, stream);
        hipLaunchKernelGGL(k_gate_merge, dim3(2048), dim3(256), 0, stream, (const float*)t1, (const float*)t2, p);
        launch_gemm((const bf16_t*)(ws + WS_MERGED), (const bf16_t*)(ws + WS_WO) + l * WO_L, MROWS, DM, DM, pg8::EpiF32{y, nullptr, DM, 0}, stream);
        hipLaunchKernelGGL(k_rownorm, dim3(256), dim3(NTHREADS), 0, stream, (const float*)y, p.norm_post_mix + (size_t)l * DM, p);
        for (int c = 0; c < NB; ++c) {
            float* U = (float*)(ws + WS_SCR);
            launch_gemm(xb + (size_t)c * SEQ * DM, (const bf16_t*)(ws + WS_WUP) + l * WUP_L, SEQ, 2 * DFF, DM, pg8::EpiF32{U, nullptr, 2 * DFF, 0}, stream);
            hipLaunchKernelGGL(k_conv_act, dim3(2048), dim3(256), 0, stream, (const float*)U, c * SEQ, SEQ, p, l);
        }
        launch_gemm((const bf16_t*)(ws + WS_ACT), (const bf16_t*)(ws + WS_WD) + l * WD_L, MROWS, DM, DFF, pg8::EpiF32{y, nullptr, DM, 0}, stream);
        hipLaunchKernelGGL(k_rownorm, dim3(256), dim3(NTHREADS), 0, stream, (const float*)y, p.norm_post_ffn + (size_t)l * DM, p);
    }
}
```
